# Optimizing an MI355X kernel written in HIP

```python
import jax, jax.numpy as jnp
from jax import lax
import numpy as np

D_MODEL = 1024
BATCH = 32
SEQ = 256
DEPTH = 2
DEC_BATCH = 2
DEC_SEQ = 1024
PAST_LEN = 512

GRID_W = 64
N_HEADS = 8
N_KV_HEADS = 2
HEAD_DIM = 64
ATTN_WIDTH = N_HEADS * HEAD_DIM
KV_WIDTH = N_KV_HEADS * HEAD_DIM
CONV_WIDTH = D_MODEL // 2
CONV_K = 3
IN_WIDTH = ATTN_WIDTH + 2 * KV_WIDTH + 3 * CONV_WIDTH
MIX_WIDTH = ATTN_WIDTH + CONV_WIDTH
D_FF = 2816
POOL_WINDOWS = (2, 4, 8, 16)
POOL_GROUP = D_MODEL // len(POOL_WINDOWS)
N_EVEN = (DEPTH + 1) // 2
N_ODD = DEPTH // 2
N_MOD = 9
Q_BLOCK = 128
ROPE_THETA = 10000.0
EPS = 1e-6

kernel_name = "hybrid_prefix_diffusion_step"


def rms_norm(x, g):
    xf = x.astype(jnp.float32)
    y = xf * lax.rsqrt(jnp.mean(xf * xf, axis=-1, keepdims=True) + EPS)
    return (y * g.astype(jnp.float32)).astype(x.dtype)


def modulate(x, g, shift, scale):
    return rms_norm(x, g) * (1 + scale[:, None, :]) + shift[:, None, :]


def swiglu(h, w1, w2):
    gate, up = jnp.split(h @ w1, 2, axis=-1)
    return (jax.nn.silu(gate) * up) @ w2


def rope_half(x, ang):
    cos = jnp.cos(ang)[None, :, None, :].astype(x.dtype)
    sin = jnp.sin(ang)[None, :, None, :].astype(x.dtype)
    x1, x2 = jnp.split(x, 2, axis=-1)
    return jnp.concatenate([x1 * cos - x2 * sin, x2 * cos + x1 * sin], axis=-1)


def axial_rope(x):
    rows = x.shape[1] // GRID_W
    t = jnp.arange(rows * GRID_W)
    row = (t // GRID_W).astype(jnp.float32)
    col = (t % GRID_W).astype(jnp.float32)
    half = HEAD_DIM // 2
    inv = ROPE_THETA ** (-jnp.arange(0, half, 2, dtype=jnp.float32) / half)
    xr, xc = jnp.split(x, 2, axis=-1)
    return jnp.concatenate([rope_half(xr, row[:, None] * inv[None, :]),
                            rope_half(xc, col[:, None] * inv[None, :])], axis=-1)


def attention(q, k, v):
    B, S = q.shape[:2]
    nb = S // Q_BLOCK
    G = N_HEADS // N_KV_HEADS
    qb = q.reshape(B, nb, Q_BLOCK, N_KV_HEADS, G, HEAD_DIM).transpose(1, 0, 2, 3, 4, 5)
    scale = HEAD_DIM ** -0.5

    def block(qi):
        s = jnp.einsum('bqhgd,bkhd->bhgqk', qi, k).astype(jnp.float32) * scale
        p = jax.nn.softmax(s, axis=-1).astype(v.dtype)
        return jnp.einsum('bhgqk,bkhd->bqhgd', p, v)

    o = lax.map(block, qb)
    return o.transpose(1, 0, 2, 3, 4, 5).reshape(B, S, ATTN_WIDTH)


def short_conv(x, w):
    S = x.shape[1]
    xp = jnp.pad(x, ((0, 0), (1, 1), (0, 0)))
    return xp[:, 0:S] * w[0] + xp[:, 1:S + 1] * w[1] + xp[:, 2:S + 2] * w[2]


def conv_attn_mixer(h, w_in, w_out, q_g, k_g, conv_w, ctx_kv):
    B, S, _ = h.shape
    splits = np.cumsum([ATTN_WIDTH, KV_WIDTH, KV_WIDTH, CONV_WIDTH, CONV_WIDTH]).tolist()
    q, k, v, bg, cg, xc = jnp.split(h @ w_in, splits, axis=-1)
    q = rms_norm(q.reshape(B, S, N_HEADS, HEAD_DIM), q_g)
    k = rms_norm(k.reshape(B, S, N_KV_HEADS, HEAD_DIM), k_g)
    v = v.reshape(B, S, N_KV_HEADS, HEAD_DIM)
    if ctx_kv is None:
        attn = attention(q, k, v)
        new_kv = (k, v)
    else:
        ck, cv = ctx_kv
        attn = attention(axial_rope(q),
                         jnp.concatenate([ck, axial_rope(k)], axis=1),
                         jnp.concatenate([cv, v], axis=1))
        new_kv = None
    conv = bg * short_conv(cg * xc, conv_w)
    return jnp.concatenate([attn, conv], axis=-1) @ w_out, new_kv


def pool_mixer(h, pool_w, pool_scale):
    B, S, D = h.shape
    hf = h.astype(jnp.float32)
    cs = jnp.concatenate([jnp.zeros((B, 1, D), jnp.float32), jnp.cumsum(hf, axis=1)], axis=1)
    t = jnp.arange(S)
    outs = []
    for gi, w in enumerate(POOL_WINDOWS):
        left = w // 2
        right = w - 1 - left
        lo = jnp.maximum(t - left, 0)
        hi = jnp.minimum(t + right + 1, S)
        sl = slice(gi * POOL_GROUP, (gi + 1) * POOL_GROUP)
        csg = cs[:, :, sl]
        mean = (csg[:, hi] - csg[:, lo]) / (hi - lo).astype(jnp.float32)[None, :, None]
        diff = (mean - hf[:, :, sl]).astype(h.dtype)
        outs.append(diff @ pool_w[gi])
    return jnp.concatenate(outs, axis=-1) * pool_scale


def run_trunk(x, cvec, cache_k, cache_v, ada_w, ada_b, norm_g, ffn_w1, ffn_w2,
              mix_w_in, mix_w_out, q_norm, k_norm, conv_w, pool_w, pool_scale, final_g):
    is_ctx = cache_k is None
    ks, vs = [], []
    for l in range(DEPTH):
        mod = jax.nn.silu(cvec) @ ada_w[l] + ada_b[l]
        sh1, sc1, g1, sh2, sc2, g2, sh3, sc3, g3 = jnp.split(mod, N_MOD, axis=-1)
        x = x + 0.5 * g1[:, None, :] * swiglu(modulate(x, norm_g[l, 0], sh1, sc1),
                                              ffn_w1[l, 0], ffn_w2[l, 0])
        h = modulate(x, norm_g[l, 1], sh2, sc2)
        if l % 2 == 0:
            e = l // 2
            ctx_kv = None if is_ctx else (cache_k[:, e], cache_v[:, e])
            out, kv = conv_attn_mixer(h, mix_w_in[e], mix_w_out[e], q_norm[e], k_norm[e],
                                      conv_w[e], ctx_kv)
            if is_ctx:
                ks.append(kv[0])
                vs.append(kv[1])
        else:
            o = l // 2
            out = pool_mixer(h, pool_w[o], pool_scale[o])
        x = x + g2[:, None, :] * out
        x = x + 0.5 * g3[:, None, :] * swiglu(modulate(x, norm_g[l, 2], sh3, sc3),
                                              ffn_w1[l, 1], ffn_w2[l, 1])
    return rms_norm(x, final_g), ks, vs


def setup_inputs(seed: int = 0) -> dict:
    key = jax.random.key(seed)
    ks = jax.random.split(key, 20)
    f32 = jnp.float32
    n = lambda k, s, sc: jax.random.normal(k, s, f32) * sc
    return {
        "x_prompt": n(ks[0], (BATCH, SEQ, D_MODEL), 1.0),
        "x_sample": n(ks[1], (DEC_BATCH, DEC_SEQ, D_MODEL), 1.0),
        "c": n(ks[2], (DEC_BATCH, D_MODEL), 1.0),
        "cache_k": n(ks[3], (DEC_BATCH, N_EVEN, PAST_LEN, N_KV_HEADS, HEAD_DIM), 1.0),
        "cache_v": n(ks[4], (DEC_BATCH, N_EVEN, PAST_LEN, N_KV_HEADS, HEAD_DIM), 1.0),
        "c_ctx": n(ks[5], (D_MODEL,), 1.0),
        "ada_w": n(ks[6], (DEPTH, D_MODEL, N_MOD * D_MODEL), 0.5 * D_MODEL ** -0.5),
        "ada_b": n(ks[7], (DEPTH, N_MOD * D_MODEL), 0.02),
        "norm_g": 1.0 + n(ks[8], (DEPTH, 3, D_MODEL), 0.1),
        "ffn_w1": n(ks[9], (DEPTH, 2, D_MODEL, 2 * D_FF), D_MODEL ** -0.5),
        "ffn_w2": n(ks[10], (DEPTH, 2, D_FF, D_MODEL), D_FF ** -0.5),
        "mix_w_in": n(ks[11], (N_EVEN, D_MODEL, IN_WIDTH), D_MODEL ** -0.5),
        "mix_w_out": n(ks[12], (N_EVEN, MIX_WIDTH, D_MODEL), MIX_WIDTH ** -0.5),
        "q_norm": 1.0 + n(ks[13], (N_EVEN, HEAD_DIM), 0.1),
        "k_norm": 1.0 + n(ks[14], (N_EVEN, HEAD_DIM), 0.1),
        "conv_w": n(ks[15], (N_EVEN, CONV_K, CONV_WIDTH), CONV_K ** -0.5),
        "pool_w": n(ks[16], (N_ODD, len(POOL_WINDOWS), POOL_GROUP, POOL_GROUP), POOL_GROUP ** -0.5),
        "pool_scale": 1.0 + n(ks[17], (N_ODD, D_MODEL), 0.1),
        "final_g": 1.0 + n(ks[18], (D_MODEL,), 0.1),
    }


def reference(x_prompt, x_sample, c, cache_k, cache_v, c_ctx, ada_w, ada_b, norm_g, ffn_w1, ffn_w2,
              mix_w_in, mix_w_out, q_norm, k_norm, conv_w, pool_w, pool_scale, final_g):
    weights = (ada_w, ada_b, norm_g, ffn_w1, ffn_w2, mix_w_in, mix_w_out, q_norm, k_norm,
               conv_w, pool_w, pool_scale, final_g)
    y_prompt, ks, vs = run_trunk(x_prompt, c_ctx[None, :], None, None, *weights)
    new_cache_k = jnp.stack(ks, axis=1)
    new_cache_v = jnp.stack(vs, axis=1)
    y_sample, _, _ = run_trunk(x_sample, c, cache_k, cache_v, *weights)
    return (y_prompt, y_sample, new_cache_k, new_cache_v)
```

```cpp
#include <hip/hip_runtime.h>
#include <cstdio>
#include <cstdint>

#define LAS __attribute__((address_space(3)))
typedef unsigned short bf16_t;
typedef short bf16x8 __attribute__((ext_vector_type(8)));
typedef short s16x4 __attribute__((ext_vector_type(4)));
typedef float f32x4 __attribute__((ext_vector_type(4)));
typedef float f32x16 __attribute__((ext_vector_type(16)));
typedef unsigned u32x4 __attribute__((ext_vector_type(4)));
typedef unsigned u32x2 __attribute__((ext_vector_type(2)));

constexpr int D = 1024, MC = 8192, ML = 2048, M = MC + ML, FF = 2816, FF2 = 5632, INW = 2304;
constexpr int SEQ_C = 256, SEQ_L = 1024, PAST = 512, KV_L = PAST + SEQ_L;
constexpr int NMOD = 9 * D;
constexpr float EPS = 1e-6f;
constexpr float QSCALE = 0.125f * 1.4426950408889634f;

constexpr size_t MiB = 1u << 20;
constexpr size_t WS_CTL = 0, CTL_ZERO_BYTES = 64 * 1024;
constexpr size_t WS_MOD = 1 * MiB;
constexpr size_t WS_ROPE = 1 * MiB + 256 * 1024;
constexpr size_t WS_RSTD = 1 * MiB + 512 * 1024;
constexpr size_t WS_W1T = 2 * MiB;
constexpr size_t WS_W2T = 46 * MiB;
constexpr size_t WS_WINT = 68 * MiB;
constexpr size_t WS_WOUTT = 73 * MiB;
constexpr size_t WS_WPOOLT = 75 * MiB;
constexpr size_t WS_HB = 76 * MiB;
constexpr size_t WS_ACT = 96 * MiB;
constexpr size_t WS_QB = 151 * MiB;
constexpr size_t WS_UB = 161 * MiB;
constexpr size_t WS_BGB = 171 * MiB;
constexpr size_t WS_KC = 181 * MiB;
constexpr size_t WS_VC = 183 * MiB;
constexpr size_t WS_KL = 185 * MiB;
constexpr size_t WS_VL = 186 * MiB;
constexpr size_t WS_END = 187 * MiB;

#define GAS __attribute__((address_space(1)))
__device__ __forceinline__ f32x4 ldg4(const float* p) { return *(const GAS f32x4*)p; }
__device__ __forceinline__ void stg4(float* p, f32x4 v) { *(GAS f32x4*)p = v; }
__device__ __forceinline__ void stg_u2(bf16_t* p, u32x2 v) { *(GAS u32x2*)p = v; }
__device__ __forceinline__ void stg_u4(bf16_t* p, u32x4 v) { *(GAS u32x4*)p = v; }
__device__ __forceinline__ u32x4 ldg_u4(const bf16_t* p) { return *(const GAS u32x4*)p; }
__device__ __forceinline__ unsigned cvt_pk_bf16(float lo, float hi) { unsigned r; asm volatile("v_cvt_pk_bf16_f32 %0, %1, %2" : "=v"(r) : "v"(lo), "v"(hi)); return r; }
__device__ __forceinline__ float wave_sum(float v) {
#pragma unroll
    for (int o = 1; o < 64; o <<= 1) v += __shfl_xor(v, o);
    return v;
}
__device__ __forceinline__ float fast_exp2(float x) { return __builtin_amdgcn_exp2f(x); }
__device__ __forceinline__ float fast_rcp(float x) { return __builtin_amdgcn_rcpf(x); }
__device__ __forceinline__ float silu_f(float g) { return g * fast_rcp(1.0f + fast_exp2(-1.4426950408889634f * g)); }

namespace pg8 {
constexpr int BM = 256, BK = 64, HALF = 128, HTB = HALF * BK * 2, STAGE_BYTES = 8 * HTB, NXCD = 8, WGM = 8;
__host__ __device__ __forceinline__ int lds_byte(int r, int c) { const int st = (r >> 4) * 2 + (c >> 5), rr = r & 15, cc = c & 31, ob = rr * 64 + cc * 2; return st * 1024 + (ob ^ (((ob >> 9) & 1) << 5)); }
__host__ __device__ __forceinline__ void stage_rc(int b, int& R, int& C) { const int st = b / 1024, sb = b % 1024, swz = sb ^ (((sb >> 9) & 1) << 5); R = (st >> 1) * 16 + swz / 64; C = (st & 1) * 32 + (swz % 64) / 2; }

struct Unit { int pm, pn; };
struct Gemm { const bf16_t* A; const bf16_t* Bt; int lda, ldb, K, a_pn_off; };

struct StaticOrder {
    int nM, nN, nwg, G, c;
    __device__ void init(int M_, int N_, int G_, int c_) { nM = M_ / BM; nN = N_ / BM; nwg = nM * nN; G = G_; c = c_; }
    __device__ bool next(int i, Unit& u) const {
        const long L = (long)i * G + c; if (L >= nwg) return false;
        int wgid = (int)L; { const int q = nwg / NXCD, r = nwg % NXCD, xcd = wgid % NXCD, off = wgid / NXCD; wgid = (xcd < r ? xcd * (q + 1) : r * (q + 1) + (xcd - r) * q) + off; }
        const int nig = WGM * nN, gid = wgid / nig, fm = gid * WGM, gsz = (nM - fm) < WGM ? (nM - fm) : WGM;
        u.pm = fm + ((wgid % nig) % gsz); u.pn = (wgid % nig) / gsz; return true;
    }
};

template <class Epi>
__device__ __forceinline__ void gemm_phase(LAS unsigned char* lds, const Gemm g, const StaticOrder S, const Epi E, const int tid) {
    const int wid = __builtin_amdgcn_readfirstlane(tid >> 6), lane = tid & 63, wr = wid >> 2, wc = wid & 3, fr = lane & 15, fq = lane >> 4;
    const int K = g.K, nt = K / BK;
    unsigned voffA[2], voffB[2];
#pragma unroll
    for (int i = 0; i < 2; ++i) { int R, C; stage_rc(tid * 16 + i * 8192, R, C);
        voffA[i] = (unsigned)(R * g.lda + C) * 2u; voffB[i] = (unsigned)(R * g.ldb + C) * 2u; }
    const size_t kstep = (size_t)(BK * 2);
    const size_t hstepA = (size_t)HALF * g.lda * 2, hstepB = (size_t)HALF * g.ldb * 2;
    const unsigned ldsw = (unsigned)wid * 1024u;
    const int aoff = lds_byte(wr * 64 + fr, fq * 8), boff = lds_byte(wc * 32 + fr, fq * 8);
#define PG8_SA(b, h) (((b) * 2 + (h)) * HTB)
#define PG8_SB(b, h) ((4 + (b) * 2 + (h)) * HTB)
#define PG8_STAGE(bufoff, gbase, voff) do { _Pragma("unroll") for (int _i = 0; _i < 2; ++_i) \
        __builtin_amdgcn_global_load_lds((const unsigned*)((const char*)(gbase) + (voff)[_i]), (LAS unsigned*)(lds + (bufoff) + ldsw + _i * 8192), 16, 0, 0); } while (0)
#define PG8_LDA(dst, b, h) do { _Pragma("unroll") for (int m = 0; m < 4; ++m) _Pragma("unroll") for (int k = 0; k < 2; ++k) dst[m][k] = *(const LAS bf16x8*)(lds + PG8_SA(b, h) + aoff + m * 2048 + k * 1024); } while (0)
#define PG8_LDB(dst, b, h) do { _Pragma("unroll") for (int n = 0; n < 2; ++n) _Pragma("unroll") for (int k = 0; k < 2; ++k) dst[n][k] = *(const LAS bf16x8*)(lds + PG8_SB(b, h) + boff + n * 2048 + k * 1024); } while (0)
#define PG8_MMA(ai, bj, At, Bt) do { __builtin_amdgcn_s_setprio(1); _Pragma("unroll") for (int m = 0; m < 4; ++m) _Pragma("unroll") for (int n = 0; n < 2; ++n) _Pragma("unroll") for (int k = 0; k < 2; ++k) \
        acc[ai][bj][m][n] = __builtin_amdgcn_mfma_f32_16x16x32_bf16(Bt[n][k], At[m][k], acc[ai][bj][m][n], 0, 0, 0); __builtin_amdgcn_s_setprio(0); } while (0)
#define PG8_WAIT_V(n) asm volatile("s_waitcnt vmcnt(" #n ")" ::: "memory")
#define PG8_WAIT_L(n) asm volatile("s_waitcnt lgkmcnt(" #n ")" ::: "memory")
#define PG8_BAR __builtin_amdgcn_s_barrier()
#define PG8_SCHED __builtin_amdgcn_sched_barrier(0)
#define PG8_UA(u) ((const char*)g.A + ((size_t)(u).pm * BM * g.lda + (size_t)(u).pn * g.a_pn_off) * 2)
#define PG8_UB(u) ((const char*)g.Bt + (size_t)(u).pn * BM * g.ldb * 2)
    Unit cur, nxt; int ui = 0;
    if (!S.next(0, cur)) return;
    f32x4 acc[2][2][4][2];
#pragma unroll
    for (int a = 0; a < 2; ++a)
#pragma unroll
        for (int b = 0; b < 2; ++b)
#pragma unroll
            for (int m = 0; m < 4; ++m)
#pragma unroll
                for (int n = 0; n < 2; ++n) acc[a][b][m][n] = (f32x4){0.f, 0.f, 0.f, 0.f};
    bf16x8 At[4][2], B0[2][2], B1[2][2];
    const char* cA = PG8_UA(cur); const char* cB = PG8_UB(cur);
    PG8_STAGE(PG8_SB(0, 0), cB, voffB); PG8_STAGE(PG8_SB(0, 1), cB + hstepB, voffB); PG8_STAGE(PG8_SA(0, 0), cA, voffA); PG8_STAGE(PG8_SA(0, 1), cA + hstepA, voffA);
    if (wr == 1) PG8_BAR;
    PG8_WAIT_V(2); PG8_BAR;
    PG8_STAGE(PG8_SB(1, 0), cB + kstep, voffB); PG8_STAGE(PG8_SA(1, 0), cA + kstep, voffA); PG8_STAGE(PG8_SB(1, 1), cB + hstepB + kstep, voffB);
    PG8_WAIT_V(6); PG8_BAR;
    for (;;) {
        const bool has_next = S.next(ui + 1, nxt);
        const char* nA = has_next ? PG8_UA(nxt) : cA; const char* nB = has_next ? PG8_UB(nxt) : cB;
        for (int t = 0; t < nt; t += 2) {
            const bool last = (t == nt - 2);
            const char* a1 = cA + (size_t)(t + 1) * kstep;
            const char* a2 = last ? nA : cA + (size_t)(t + 2) * kstep; const char* b2 = last ? nB : cB + (size_t)(t + 2) * kstep;
            const char* a3 = a2 + kstep; const char* b3 = b2 + kstep;
            PG8_LDB(B0, 0, 0); PG8_LDB(B1, 0, 1); PG8_SCHED; PG8_LDA(At, 0, 0); PG8_STAGE(PG8_SA(1, 1), a1 + hstepA, voffA);
            PG8_WAIT_V(8); PG8_WAIT_L(0); PG8_BAR; PG8_MMA(0, 0, At, B0); PG8_MMA(0, 1, At, B1); PG8_BAR; PG8_SCHED;
            PG8_LDA(At, 0, 1); PG8_STAGE(PG8_SB(0, 0), b2, voffB); PG8_STAGE(PG8_SB(0, 1), b2 + hstepB, voffB); PG8_STAGE(PG8_SA(0, 0), a2, voffA);
            PG8_WAIT_V(8); PG8_WAIT_L(0); PG8_BAR; PG8_MMA(1, 0, At, B0); PG8_MMA(1, 1, At, B1); PG8_BAR; PG8_SCHED;
            PG8_LDB(B0, 1, 0); PG8_LDB(B1, 1, 1); PG8_SCHED; PG8_LDA(At, 1, 0); PG8_STAGE(PG8_SA(0, 1), a2 + hstepA, voffA);
            PG8_WAIT_V(8); PG8_WAIT_L(0); PG8_BAR; PG8_MMA(0, 0, At, B0); PG8_MMA(0, 1, At, B1); PG8_BAR; PG8_SCHED;
            PG8_LDA(At, 1, 1); PG8_STAGE(PG8_SB(1, 0), b3, voffB); PG8_STAGE(PG8_SB(1, 1), b3 + hstepB, voffB); PG8_STAGE(PG8_SA(1, 0), a3, voffA);
            PG8_WAIT_V(8); PG8_WAIT_L(0); PG8_BAR; PG8_MMA(1, 0, At, B0); PG8_MMA(1, 1, At, B1); PG8_BAR; PG8_SCHED;
        }
        if (wr == 0) PG8_BAR;
        E(acc, cur, wr, wc, fr, fq, lane);
        if (!has_next) break;
#pragma unroll
        for (int a = 0; a < 2; ++a)
#pragma unroll
            for (int b = 0; b < 2; ++b)
#pragma unroll
                for (int m = 0; m < 4; ++m)
#pragma unroll
                    for (int n = 0; n < 2; ++n) acc[a][b][m][n] = (f32x4){0.f, 0.f, 0.f, 0.f};
        cur = nxt; cA = nA; cB = nB; ++ui;
        if (wr == 1) PG8_BAR;
    }
    PG8_WAIT_V(0);
    PG8_BAR;
#undef PG8_SA
#undef PG8_SB
#undef PG8_STAGE
#undef PG8_LDA
#undef PG8_LDB
#undef PG8_MMA
#undef PG8_WAIT_V
#undef PG8_WAIT_L
#undef PG8_BAR
#undef PG8_SCHED
#undef PG8_UA
#undef PG8_UB
}
}

typedef const f32x4 (&AccRef)[2][2][4][2];

struct EpiSwiglu {
    bf16_t* O;
    __device__ __forceinline__ void operator()(AccRef acc, const pg8::Unit& u, int wr, int wc, int fr, int fq, int lane) const {
        const int row0 = u.pm * 256 + wr * 64 + fr, col0 = u.pn * 128 + wc * 32 + 8 * fq;
#pragma unroll
        for (int ai = 0; ai < 2; ++ai)
#pragma unroll
            for (int m = 0; m < 4; ++m) {
                const f32x4 g0 = acc[ai][0][m][0], g1 = acc[ai][0][m][1], u0 = acc[ai][1][m][0], u1 = acc[ai][1][m][1];
                u32x4 w;
                w.x = cvt_pk_bf16(silu_f(g0[0]) * u0[0], silu_f(g0[1]) * u0[1]); w.y = cvt_pk_bf16(silu_f(g0[2]) * u0[2], silu_f(g0[3]) * u0[3]);
                w.z = cvt_pk_bf16(silu_f(g1[0]) * u1[0], silu_f(g1[1]) * u1[1]); w.w = cvt_pk_bf16(silu_f(g1[2]) * u1[2], silu_f(g1[3]) * u1[3]);
                stg_u4(O + (size_t)(row0 + ai * 128 + m * 16) * FF + col0, w);
            }
    }
};

struct EpiResid {
    const float* xin_c; const float* xin_l;
    float* out; const float* gate; const float* colscale; float coef; float pad_;
    __device__ __forceinline__ void operator()(AccRef acc, const pg8::Unit& u, int wr, int wc, int fr, int fq, int lane) const {
        const int row0 = u.pm * 256 + wr * 64 + fr, col0 = u.pn * 256 + wc * 32 + 4 * fq;
        const int set = u.pm < 32 ? 0 : 1 + ((u.pm - 32) >> 2);
        const float* xin = u.pm < 32 ? xin_c : xin_l - (size_t)MC * D;
        f32x4 gv[2][2];
#pragma unroll
        for (int bj = 0; bj < 2; ++bj)
#pragma unroll
            for (int n = 0; n < 2; ++n) { gv[bj][n] = ldg4(gate + set * NMOD + col0 + bj * 128 + n * 16) * coef;
                if (colscale) gv[bj][n] = gv[bj][n] * ldg4(colscale + col0 + bj * 128 + n * 16); }
#pragma unroll
        for (int ai = 0; ai < 2; ++ai)
#pragma unroll
            for (int m = 0; m < 4; ++m) { const size_t off = (size_t)(row0 + ai * 128 + m * 16) * D + col0;
#pragma unroll
                for (int bj = 0; bj < 2; ++bj)
#pragma unroll
                    for (int n = 0; n < 2; ++n) { const f32x4 xv = ldg4(xin + off + bj * 128 + n * 16);
                        stg4(out + off + bj * 128 + n * 16, xv + gv[bj][n] * acc[ai][bj][m][n]); } }
    }
};

struct EpiInproj {
    bf16_t *Qb, *Kc, *Vc, *Kl, *Vl, *Ub, *BGb; float* outK; float* outV;
    const float* q_g; const float* k_g; const float* rope;
    __device__ __forceinline__ void operator()(AccRef acc, const pg8::Unit& u, int wr, int wc, int fr, int fq, int lane) const {
        const int row0 = u.pm * 256 + wr * 64 + fr;
        const bool lat = u.pm >= 32;
        if (u.pn <= 2) {
            const bool isq = u.pn < 2, isv = (u.pn == 2) && (wc >= 2);
            const float* gsrc = isq ? q_g : k_g;
            f32x4 gn[2][2];
#pragma unroll
            for (int bj = 0; bj < 2; ++bj)
#pragma unroll
                for (int n = 0; n < 2; ++n) gn[bj][n] = ldg4(gsrc + 32 * bj + 16 * n + 4 * fq);
#pragma unroll
            for (int ai = 0; ai < 2; ++ai)
#pragma unroll
                for (int m = 0; m < 4; ++m) {
                    const int row = row0 + ai * 128 + m * 16;
                    f32x4 v[2][2];
#pragma unroll
                    for (int bj = 0; bj < 2; ++bj)
#pragma unroll
                        for (int n = 0; n < 2; ++n) v[bj][n] = acc[ai][bj][m][n];
                    if (!isv) {
                        float ss = 0.f;
#pragma unroll
                        for (int bj = 0; bj < 2; ++bj)
#pragma unroll
                            for (int n = 0; n < 2; ++n) ss += (v[bj][n][0] * v[bj][n][0] + v[bj][n][1] * v[bj][n][1]) + (v[bj][n][2] * v[bj][n][2] + v[bj][n][3] * v[bj][n][3]);
                        ss += __shfl_xor(ss, 16); ss += __shfl_xor(ss, 32);
                        const float rstd = rsqrtf(ss * (1.0f / 64.0f) + EPS);
#pragma unroll
                        for (int bj = 0; bj < 2; ++bj)
#pragma unroll
                            for (int n = 0; n < 2; ++n) v[bj][n] = v[bj][n] * rstd * gn[bj][n];
                        if (lat) {
                            const int t = (row - MC) & (SEQ_L - 1);
#pragma unroll
                            for (int bj = 0; bj < 2; ++bj) {
                                const int pos = bj == 0 ? (t >> 6) : (t & 63);
                                const f32x4 cs0 = ldg4(rope + (pos * 16 + 4 * fq) * 2), cs1 = ldg4(rope + (pos * 16 + 4 * fq) * 2 + 4);
                                const float cc[4] = {cs0[0], cs0[2], cs1[0], cs1[2]}, sn[4] = {cs0[1], cs0[3], cs1[1], cs1[3]};
#pragma unroll
                                for (int j = 0; j < 4; ++j) { const float x1 = v[bj][0][j], x2 = v[bj][1][j]; v[bj][0][j] = x1 * cc[j] - x2 * sn[j]; v[bj][1][j] = x2 * cc[j] + x1 * sn[j]; }
                            }
                        }
                    }
                    if (isq) {
                        bf16_t* dst = Qb + (size_t)row * 512 + (4 * u.pn + wc) * 64 + 4 * fq;
#pragma unroll
                        for (int bj = 0; bj < 2; ++bj)
#pragma unroll
                            for (int n = 0; n < 2; ++n) { u32x2 w; w.x = cvt_pk_bf16(v[bj][n][0] * QSCALE, v[bj][n][1] * QSCALE); w.y = cvt_pk_bf16(v[bj][n][2] * QSCALE, v[bj][n][3] * QSCALE);
                                stg_u2(dst + 32 * bj + 16 * n, w); }
                    } else {
                        const int hh = wc & 1;
                        bf16_t* dst; float* fdst = nullptr;
                        if (!lat) { dst = (isv ? Vc : Kc) + (size_t)row * 128 + hh * 64 + 4 * fq; fdst = (isv ? outV : outK) + (size_t)row * 128 + hh * 64 + 4 * fq; }
                        else { const int rl = row - MC, b = rl >> 10, t = rl & 1023; dst = (isv ? Vl : Kl) + ((size_t)b * KV_L + PAST + t) * 128 + hh * 64 + 4 * fq; }
#pragma unroll
                        for (int bj = 0; bj < 2; ++bj)
#pragma unroll
                            for (int n = 0; n < 2; ++n) { u32x2 w; w.x = cvt_pk_bf16(v[bj][n][0], v[bj][n][1]); w.y = cvt_pk_bf16(v[bj][n][2], v[bj][n][3]);
                                stg_u2(dst + 32 * bj + 16 * n, w);
                                if (!lat) stg4(fdst + 32 * bj + 16 * n, v[bj][n]); }
                    }
                }
        } else if (u.pn <= 4) {
            const int col0 = (u.pn - 3) * 256 + wc * 32 + 4 * fq;
#pragma unroll
            for (int ai = 0; ai < 2; ++ai)
#pragma unroll
                for (int m = 0; m < 4; ++m) { bf16_t* dst = BGb + (size_t)(row0 + ai * 128 + m * 16) * 512 + col0;
#pragma unroll
                    for (int bj = 0; bj < 2; ++bj)
#pragma unroll
                        for (int n = 0; n < 2; ++n) { const f32x4 a = acc[ai][bj][m][n]; u32x2 w; w.x = cvt_pk_bf16(a[0], a[1]); w.y = cvt_pk_bf16(a[2], a[3]); stg_u2(dst + bj * 128 + n * 16, w); } }
        } else {
            const int col0 = (u.pn - 5) * 128 + wc * 32 + 4 * fq;
#pragma unroll
            for (int ai = 0; ai < 2; ++ai)
#pragma unroll
                for (int m = 0; m < 4; ++m) { bf16_t* dst = Ub + (size_t)(row0 + ai * 128 + m * 16) * 512 + col0;
#pragma unroll
                    for (int n = 0; n < 2; ++n) { const f32x4 a = acc[ai][0][m][n] * acc[ai][1][m][n]; u32x2 w; w.x = cvt_pk_bf16(a[0], a[1]); w.y = cvt_pk_bf16(a[2], a[3]); stg_u2(dst + n * 16, w); } }
        }
    }
};

#define XB_TMO      128
#define XB_XCNT(j)  (256  + 64 * (j))
#define XB_XSUB(j)  (1280 + 64 * (j))
#define XB_XGEN(j)  (2304 + 64 * (j))
#define XB_TOP      3328
#define XB_TOPGEN   3392
#define XCD_BAR_WORDS 3456
#define XB_SPIN_CAP (1u << 20)
__device__ __forceinline__ unsigned xb_ld(unsigned* p)              { return __hip_atomic_load(p, __ATOMIC_RELAXED, __HIP_MEMORY_SCOPE_AGENT); }
__device__ __forceinline__ unsigned xb_add(unsigned* p, unsigned v) { return __hip_atomic_fetch_add(p, v, __ATOMIC_RELAXED, __HIP_MEMORY_SCOPE_AGENT); }
__device__ __forceinline__ unsigned xb_xcc_id() { return (unsigned)__builtin_amdgcn_s_getreg((3 << 11) | 20) & 0xFu; }
#define XB_SPIN(cond, bar) do { unsigned _sp = 0; while (cond) { __builtin_amdgcn_s_sleep(1); \
    if ((++_sp & 255u) == 0u) { if (xb_ld(&(bar)[XB_TMO])) break; if (_sp > XB_SPIN_CAP) { atomicAdd(&(bar)[XB_TMO], 1u); break; } } } } while (0)
struct XcdBarrier { unsigned* bar; unsigned x; volatile LAS unsigned* st; };
__device__ __forceinline__ XcdBarrier xcd_barrier_post(unsigned* bar, volatile LAS unsigned* st) {
    XcdBarrier b; b.bar = bar; b.x = xb_xcc_id(); b.st = st;
    if (threadIdx.x == 0) (void)xb_add(&bar[XB_XCNT(b.x)], 1u);
    return b;
}
__device__ __forceinline__ void xcd_barrier_complete(unsigned* bar, unsigned x, unsigned& nloc, unsigned& nx) {
    const unsigned G = gridDim.x * gridDim.y * gridDim.z;
    unsigned sum, cnt, mine, sp = 0u;
    for (;;) {
        sum = 0u; cnt = 0u; mine = 0u;
#pragma unroll
        for (unsigned j = 0; j < 16; ++j) { const unsigned c = xb_ld(&bar[XB_XCNT(j)]); sum += c; cnt += (c > 0u) ? 1u : 0u; mine = (j == x) ? c : mine; }
        if (sum == G) break;
        __builtin_amdgcn_s_sleep(1);
        if ((++sp & 255u) == 0u) { if (xb_ld(&bar[XB_TMO])) break; if (sp > XB_SPIN_CAP) { atomicAdd(&bar[XB_TMO], 1u); break; } }
    }
    nloc = mine > 0u ? mine : 1u; nx = cnt > 0u ? cnt : 1u;
}
__device__ __forceinline__ void xcd_barrier(const XcdBarrier& b) {
    asm volatile("s_waitcnt vmcnt(0)" ::: "memory");
    __syncthreads();
    if (threadIdx.x == 0) {
        unsigned* bar = b.bar;
        __builtin_amdgcn_s_waitcnt(0);
        unsigned nloc = b.st[0], nx = b.st[1];
        if (nloc == 0u) { xcd_barrier_complete(bar, b.x, nloc, nx); b.st[0] = nloc; b.st[1] = nx; }
        const unsigned old = xb_add(&bar[XB_XSUB(b.x)], 1u);
        const unsigned gen = old / nloc;
        if (old + 1u == (gen + 1u) * nloc) {
            __builtin_amdgcn_fence(__ATOMIC_RELEASE, "agent");
            asm volatile("s_waitcnt vmcnt(0)" ::: "memory");
            const unsigned og = xb_add(&bar[XB_TOP], 1u);
            const unsigned tg = og / nx;
            if (og + 1u == (tg + 1u) * nx) xb_add(&bar[XB_TOPGEN], 1u);
            else XB_SPIN(xb_ld(&bar[XB_TOPGEN]) == tg, bar);
            __builtin_amdgcn_fence(__ATOMIC_ACQUIRE, "agent");
            xb_add(&bar[XB_XGEN(b.x)], 1u);
            asm volatile("s_waitcnt vmcnt(0)" ::: "memory");
        } else {
            XB_SPIN(xb_ld(&bar[XB_XGEN(b.x)]) == gen, bar);
            __builtin_amdgcn_fence(__ATOMIC_ACQUIRE, "agent");
            asm volatile("s_waitcnt vmcnt(0)" ::: "memory");
        }
    }
    __syncthreads();
}

constexpr int RING_BYTES = 131072, MISC_OFF = RING_BYTES, LDS_BYTES = 147456;
struct Args { const float* in[19]; float* out; unsigned char* ws; int pad0, pad1; };
struct Frame {
    LAS unsigned char* lds; int tid, lane, wave, G, bid;
    const float* const* in; float* out; unsigned char* ws;
};
#define F_x_prompt (F.in[0])
#define F_x_sample (F.in[1])
#define F_c (F.in[2])
#define F_cache_k (F.in[3])
#define F_cache_v (F.in[4])
#define F_c_ctx (F.in[5])
#define F_ada_w (F.in[6])
#define F_ada_b (F.in[7])
#define F_norm_g (F.in[8])
#define F_ffn_w1 (F.in[9])
#define F_ffn_w2 (F.in[10])
#define F_mix_w_in (F.in[11])
#define F_mix_w_out (F.in[12])
#define F_q_norm (F.in[13])
#define F_k_norm (F.in[14])
#define F_conv_w (F.in[15])
#define F_pool_w (F.in[16])
#define F_pool_scale (F.in[17])
#define F_final_g (F.in[18])
#define F_MOD ((float*)(F.ws + WS_MOD))
#define F_ROPE ((float*)(F.ws + WS_ROPE))
#define F_RSTD ((float*)(F.ws + WS_RSTD))
#define F_W1T ((bf16_t*)(F.ws + WS_W1T))
#define F_W2T ((bf16_t*)(F.ws + WS_W2T))
#define F_WINT ((bf16_t*)(F.ws + WS_WINT))
#define F_WOUTT ((bf16_t*)(F.ws + WS_WOUTT))
#define F_WPOOLT ((bf16_t*)(F.ws + WS_WPOOLT))
#define F_HB ((bf16_t*)(F.ws + WS_HB))
#define F_ACT ((bf16_t*)(F.ws + WS_ACT))
#define F_QB ((bf16_t*)(F.ws + WS_QB))
#define F_UB ((bf16_t*)(F.ws + WS_UB))
#define F_BGB ((bf16_t*)(F.ws + WS_BGB))
#define F_KC ((bf16_t*)(F.ws + WS_KC))
#define F_VC ((bf16_t*)(F.ws + WS_VC))
#define F_KL ((bf16_t*)(F.ws + WS_KL))
#define F_VL ((bf16_t*)(F.ws + WS_VL))

__device__ __forceinline__ int dest_row_w1(int c) { const int up = c >= FF ? 1 : 0; const int ch = c - FF * up; const int pn = ch >> 7, r = ch & 127; const int wc = r >> 5, fq = (r >> 3) & 3, n = (r >> 2) & 1, j = r & 3;
    return 256 * pn + 128 * up + 32 * wc + 16 * n + 4 * fq + j; }
__device__ __forceinline__ int dest_row_win(int c) {
    if (c < 768) { const int head = c >> 6, d = c & 63; int pn, wc; if (c < 512) { pn = head >> 2; wc = head & 3; } else { pn = 2; wc = head - 8; }
        const int bj = d >> 5, n = (d >> 4) & 1, fq = (d >> 2) & 3, j = d & 3; return 256 * pn + 128 * bj + 32 * wc + 16 * n + 4 * fq + j; }
    if (c < 1280) return c;
    if (c < 1792) { const int ch = c - 1280; return 256 * (5 + (ch >> 7)) + (ch & 127); }
    const int ch = c - 1792; return 256 * (5 + (ch >> 7)) + 128 + (ch & 127);
}
template <int MAP> __device__ __forceinline__ void p0_transpose_item(const float* W, int K, int N, bf16_t* WT, LAS float* scr, int item, int lane) {
    const int nblk = N / 32, kb = item / nblk, nb = item % nblk, k0 = 64 * kb, n0 = 32 * nb;
#pragma unroll 8
    for (int i = 0; i < 32; ++i) { const int kk = 2 * i + (lane >> 5); scr[kk * 33 + (lane & 31)] = W[(size_t)(k0 + kk) * N + n0 + (lane & 31)]; }
    asm volatile("s_waitcnt lgkmcnt(0)" ::: "memory");
    const int c = lane & 7;
#pragma unroll
    for (int j = 0; j < 4; ++j) { const int n = (lane >> 3) + 8 * j; const LAS float* s = scr + (8 * c) * 33 + n;
        u32x4 o; o.x = cvt_pk_bf16(s[0 * 33], s[1 * 33]); o.y = cvt_pk_bf16(s[2 * 33], s[3 * 33]); o.z = cvt_pk_bf16(s[4 * 33], s[5 * 33]); o.w = cvt_pk_bf16(s[6 * 33], s[7 * 33]);
        const int src = n0 + n; const int dr = MAP == 1 ? dest_row_w1(src) : (MAP == 2 ? dest_row_win(src) : src);
        stg_u4(WT + (size_t)dr * K + k0 + 8 * c, o); }
    asm volatile("s_waitcnt lgkmcnt(0)" ::: "memory");
}

__device__ __forceinline__ void p0_ada(Frame& F, int item) {
    LAS float* s = (LAS float*)(F.lds);
    LAS float* red = (LAS float*)(F.lds + 12288);
    for (int i = F.tid; i < 3072; i += 512) { const int set = i >> 10, k = i & 1023; const float* cv = set == 0 ? F_c_ctx : F_c + (set - 1) * D; const float v = cv[k]; s[i] = v / (1.0f + __expf(-v)); }
    __syncthreads();
    const int layer = item >> 7, col0 = (item & 127) * 72;
    const int c4 = F.tid % 18, kg = F.tid / 18;
    if (kg < 28) {
        f32x4 a0 = {0.f, 0.f, 0.f, 0.f}, a1 = a0, a2 = a0;
        const float* wp = F_ada_w + (size_t)layer * D * NMOD + col0 + 4 * c4;
#pragma unroll 4
        for (int k = kg; k < D; k += 28) { const f32x4 w = ldg4(wp + (size_t)k * NMOD); a0 += w * s[k]; a1 += w * s[1024 + k]; a2 += w * s[2048 + k]; }
#pragma unroll
        for (int j = 0; j < 4; ++j) { red[kg * 216 + 4 * c4 + j] = a0[j]; red[kg * 216 + 72 + 4 * c4 + j] = a1[j]; red[kg * 216 + 144 + 4 * c4 + j] = a2[j]; }
    }
    __syncthreads();
    if (F.tid < 216) { float sum = 0.f;
#pragma unroll 4
        for (int g = 0; g < 28; ++g) sum += red[g * 216 + F.tid];
        const int set = F.tid / 72, col = F.tid % 72;
        F_MOD[(size_t)(layer * 3 + set) * NMOD + col0 + col] = sum + F_ada_b[layer * NMOD + col0 + col]; }
    __syncthreads();
}

__device__ __forceinline__ void sincos_small(float a, float& sn, float& cs) {
    const float kf = rintf(a * 0.63661977236758134f); const int q = (int)kf;
    float r = fmaf(-kf, 1.5707962512969971f, a); r = fmaf(-kf, 7.5497894158615964e-08f, r); r = fmaf(-kf, 5.3903029534742384e-15f, r);
    const float r2 = r * r;
    float sp = fmaf(r2, fmaf(r2, fmaf(r2, 2.7183114939898219e-6f, -1.9839334836096632e-4f), 8.3333293858894632e-3f), -1.6666665673255920e-1f); sp = fmaf(sp * r2, r, r);
    float cp = fmaf(r2, fmaf(r2, fmaf(r2, 2.4433157118259e-5f, -1.3887316255057e-3f), 4.1666645683028e-2f), -0.5f); cp = fmaf(cp, r2, 1.0f);
    const float s0 = (q & 1) ? cp : sp, c0 = (q & 1) ? sp : cp;
    sn = (q & 2) ? -s0 : s0; cs = ((q + 1) & 2) ? -c0 : c0;
}

__device__ __forceinline__ void p0_prologue(Frame& F) {
    for (int item = F.bid; item < 256; item += F.G) p0_ada(F, item);
    const int gt = F.bid * 512 + F.tid, NGT = F.G * 512;
    if (gt < 1024) { const int pos = gt >> 4, i = gt & 15; const float inv = exp2f(-(float)i * (13.287712379549449f / 16.0f)); float sn, cs; sincos_small((float)pos * inv, sn, cs);
        F_ROPE[2 * gt] = cs; F_ROPE[2 * gt + 1] = sn; }
    for (int e = gt; e < 2 * PAST * 128 / 4; e += NGT) {
        const int b = e / (PAST * 32), r = e % (PAST * 32);
        const f32x4 kv = ldg4(F_cache_k + (size_t)e * 4), vv = ldg4(F_cache_v + (size_t)e * 4);
        u32x2 kw, vw; kw.x = cvt_pk_bf16(kv[0], kv[1]); kw.y = cvt_pk_bf16(kv[2], kv[3]); vw.x = cvt_pk_bf16(vv[0], vv[1]); vw.y = cvt_pk_bf16(vv[2], vv[3]);
        stg_u2(F_KL + (size_t)b * KV_L * 128 + (size_t)r * 4, kw); stg_u2(F_VL + (size_t)b * KV_L * 128 + (size_t)r * 4, vw);
    }
    LAS float* scr = (LAS float*)(F.lds + 40960 + F.wave * 8448);
    const int gw = F.bid * 8 + F.wave, NGW = F.G * 8;
    constexpr int I_W1 = (D / 64) * (FF2 / 32), I_W2 = (FF / 64) * (D / 32), I_IN = (D / 64) * (INW / 32), I_OUT = (D / 64) * (D / 32), I_PL = (256 / 64) * (256 / 32);
    constexpr int NITEMS = 4 * I_W1 + 4 * I_W2 + I_IN + I_OUT + 4 * I_PL;
    for (int it = gw; it < NITEMS; it += NGW) {
        int r = it;
        if (r < 4 * I_W1) { const int f = r / I_W1; p0_transpose_item<1>(F_ffn_w1 + (size_t)f * D * FF2, D, FF2, F_W1T + (size_t)f * FF2 * D, scr, r % I_W1, F.lane); continue; } r -= 4 * I_W1;
        if (r < 4 * I_W2) { const int f = r / I_W2; p0_transpose_item<0>(F_ffn_w2 + (size_t)f * FF * D, FF, D, F_W2T + (size_t)f * D * FF, scr, r % I_W2, F.lane); continue; } r -= 4 * I_W2;
        if (r < I_IN) { p0_transpose_item<2>(F_mix_w_in, D, INW, F_WINT, scr, r, F.lane); continue; } r -= I_IN;
        if (r < I_OUT) { p0_transpose_item<0>(F_mix_w_out, D, D, F_WOUTT, scr, r, F.lane); continue; } r -= I_OUT;
        { const int gi = r / I_PL; p0_transpose_item<0>(F_pool_w + (size_t)gi * 65536, 256, 256, F_WPOOLT + (size_t)gi * 65536, scr, r % I_PL, F.lane); }
    }
}

__device__ __forceinline__ void norm_pass(Frame& F, int mode, const float* xc, const float* xl, const float* g, const float* sh, const float* sc) {
    const int gw = F.bid * 8 + F.wave, NGW = F.G * 8;
    for (int row = gw; row < M; row += NGW) {
        const float* xr = (row < MC ? xc + (size_t)row * D : xl + (size_t)(row - MC) * D) + 4 * F.lane;
        f32x4 v[4]; float s = 0.f;
#pragma unroll
        for (int j = 0; j < 4; ++j) { v[j] = ldg4(xr + 256 * j); s += (v[j][0] * v[j][0] + v[j][1] * v[j][1]) + (v[j][2] * v[j][2] + v[j][3] * v[j][3]); }
        const float rstd = rsqrtf(wave_sum(s) * (1.0f / D) + EPS);
        if (mode == 1) { if (F.lane == 0) F_RSTD[row] = rstd; continue; }
        const int set = row < MC ? 0 : 1 + ((row - MC) >> 10);
#pragma unroll
        for (int j = 0; j < 4; ++j) {
            const int col = 256 * j + 4 * F.lane;
            const f32x4 gv = ldg4(g + col);
            if (mode == 2) { stg4(F.out + (size_t)row * D + col, v[j] * rstd * gv); }
            else { const f32x4 scv = ldg4(sc + set * NMOD + col), shv = ldg4(sh + set * NMOD + col);
                const f32x4 h = (v[j] * rstd * gv) * (scv + 1.0f) + shv;
                u32x2 w; w.x = cvt_pk_bf16(h[0], h[1]); w.y = cvt_pk_bf16(h[2], h[3]); stg_u2(F_HB + (size_t)row * D + col, w); }
        }
    }
}

__device__ __forceinline__ void pool_diff_pass(Frame& F, const float* g, const float* sc) {
    const int gw = F.bid * 8 + F.wave, NGW = F.G * 8;
    const float* X = F.out;
    for (int row = gw; row < M; row += NGW) {
        int s0, S, t, set;
        if (row < MC) { s0 = row & ~(SEQ_C - 1); S = SEQ_C; t = row - s0; set = 0; } else { s0 = MC + ((row - MC) & ~(SEQ_L - 1)); S = SEQ_L; t = row - s0; set = 1 + ((row - MC) >> 10); }
#pragma unroll
        for (int j = 0; j < 4; ++j) {
            const int w = 2 << j, left = w >> 1, right = w - 1 - left;
            const int lo = max(t - left, 0), hi = min(t + right + 1, S);
            const int col = 256 * j + 4 * F.lane;
            f32x4 sum = {0.f, 0.f, 0.f, 0.f}, self = sum;
            for (int r = lo; r < hi; ++r) { const f32x4 xv = ldg4(X + (size_t)(s0 + r) * D + col) * F_RSTD[s0 + r]; sum += xv; if (r == t) self = xv; }
            const f32x4 gs = ldg4(g + col) * (ldg4(sc + set * NMOD + col) + 1.0f);
            const f32x4 dv = (sum * (1.0f / (float)(hi - lo)) - self) * gs;
            u32x2 wv; wv.x = cvt_pk_bf16(dv[0], dv[1]); wv.y = cvt_pk_bf16(dv[2], dv[3]); stg_u2(F_HB + (size_t)row * D + col, wv);
        }
    }
}

constexpr int ATT_VB1 = 4096 + 64, ATT_BUF = 8192 + 8192 + 128;
__device__ __forceinline__ s16x4 vtr(const LAS unsigned char* p) { typedef short v4i16_t __attribute__((ext_vector_type(4))); return __builtin_bit_cast(s16x4, __builtin_amdgcn_ds_read_tr16_b64_v4i16((LAS v4i16_t*)p)); }
__device__ __forceinline__ void attn_unit(Frame& F, const bf16_t* Q, const bf16_t* K, const bf16_t* V, int NT, bf16_t* O) {
    const int lane = F.lane, wid = F.wave, r32 = lane & 31, hi = lane >> 5, tid = F.tid;
    LAS unsigned char* lds = F.lds;
    bf16x8 qf[4];
    { const bf16_t* qrow = Q + (size_t)(wid * 32 + r32) * 512;
#pragma unroll
      for (int s = 0; s < 4; ++s) qf[s] = *(const GAS bf16x8*)(qrow + 16 * s + 8 * hi); }
    const bf16_t* ksrc = K + (size_t)lane * 128 + wid * 8;
    const int vkey = tid >> 3, vc = tid & 7;
    const bf16_t* vsrc = V + (size_t)vkey * 128 + vc * 8;
    const int kdst = wid * 1024 + lane * 16, vdst = 8192 + (vc >> 2) * ATT_VB1 + vkey * 64 + (vc & 3) * 16;
    u32x4 kreg = ldg_u4(ksrc), vreg = ldg_u4(vsrc);
    f32x16 o0, o1;
#pragma unroll
    for (int i = 0; i < 16; ++i) { o0[i] = 0.f; o1[i] = 0.f; }
    float mrun = -1e30f, lrun = 0.f;
    const int vrd = 8192 + (4 * hi + ((lane & 15) >> 2)) * 64 + (16 * ((lane >> 4) & 1) + 4 * (lane & 3)) * 2;
    for (int t = 0; t < NT; ++t) {
        LAS unsigned char* buf = lds + (t & 1) * ATT_BUF;
        *(LAS u32x4*)(buf + kdst) = kreg; *(LAS u32x4*)(buf + vdst) = vreg;
        __syncthreads();
        if (t + 1 < NT) { kreg = ldg_u4(ksrc + (size_t)(t + 1) * 64 * 128); vreg = ldg_u4(vsrc + (size_t)(t + 1) * 64 * 128); }
        f32x16 p0, p1;
#pragma unroll
        for (int i = 0; i < 16; ++i) { p0[i] = 0.f; p1[i] = 0.f; }
#pragma unroll
        for (int s = 0; s < 4; ++s) {
            const bf16x8 a0 = *(const LAS bf16x8*)(buf + (2 * s + hi) * 1024 + r32 * 16), a1 = *(const LAS bf16x8*)(buf + (2 * s + hi) * 1024 + (32 + r32) * 16);
            p0 = __builtin_amdgcn_mfma_f32_32x32x16_bf16(a0, qf[s], p0, 0, 0, 0); p1 = __builtin_amdgcn_mfma_f32_32x32x16_bf16(a1, qf[s], p1, 0, 0, 0);
        }
        float mx = fmaxf(p0[0], p1[0]);
#pragma unroll
        for (int i = 1; i < 16; ++i) mx = fmaxf(mx, fmaxf(p0[i], p1[i]));
        mx = fmaxf(mx, __shfl_xor(mx, 32));
        const float mnew = fmaxf(mrun, mx), alpha = fast_exp2(mrun - mnew); mrun = mnew;
        float rs = 0.f;
#pragma unroll
        for (int i = 0; i < 16; ++i) { p0[i] = fast_exp2(p0[i] - mnew); p1[i] = fast_exp2(p1[i] - mnew); rs += p0[i] + p1[i]; }
        lrun = lrun * alpha + rs;
#pragma unroll
        for (int i = 0; i < 16; ++i) { o0[i] *= alpha; o1[i] *= alpha; }
        u32x4 pb[4];
        pb[0] = (u32x4){cvt_pk_bf16(p0[0], p0[1]), cvt_pk_bf16(p0[2], p0[3]), cvt_pk_bf16(p0[4], p0[5]), cvt_pk_bf16(p0[6], p0[7])};
        pb[1] = (u32x4){cvt_pk_bf16(p0[8], p0[9]), cvt_pk_bf16(p0[10], p0[11]), cvt_pk_bf16(p0[12], p0[13]), cvt_pk_bf16(p0[14], p0[15])};
        pb[2] = (u32x4){cvt_pk_bf16(p1[0], p1[1]), cvt_pk_bf16(p1[2], p1[3]), cvt_pk_bf16(p1[4], p1[5]), cvt_pk_bf16(p1[6], p1[7])};
        pb[3] = (u32x4){cvt_pk_bf16(p1[8], p1[9]), cvt_pk_bf16(p1[10], p1[11]), cvt_pk_bf16(p1[12], p1[13]), cvt_pk_bf16(p1[14], p1[15])};
#pragma unroll
        for (int ks = 0; ks < 4; ++ks) {
            const LAS unsigned char* vp = buf + vrd + ks * 16 * 64;
            const s16x4 l0 = vtr(vp), h0 = vtr(vp + 8 * 64), l1 = vtr(vp + ATT_VB1), h1 = vtr(vp + ATT_VB1 + 8 * 64);
            const bf16x8 v0 = (bf16x8){l0[0], l0[1], l0[2], l0[3], h0[0], h0[1], h0[2], h0[3]}, v1 = (bf16x8){l1[0], l1[1], l1[2], l1[3], h1[0], h1[1], h1[2], h1[3]};
            const bf16x8 pf = __builtin_bit_cast(bf16x8, pb[ks]);
            o0 = __builtin_amdgcn_mfma_f32_32x32x16_bf16(v0, pf, o0, 0, 0, 0); o1 = __builtin_amdgcn_mfma_f32_32x32x16_bf16(v1, pf, o1, 0, 0, 0);
        }
    }
    lrun += __shfl_xor(lrun, 32);
    const float inv = 1.0f / lrun;
    bf16_t* orow = O + (size_t)(wid * 32 + r32) * D;
#pragma unroll
    for (int g = 0; g < 4; ++g) {
        u32x2 w0, w1; w0.x = cvt_pk_bf16(o0[4 * g] * inv, o0[4 * g + 1] * inv); w0.y = cvt_pk_bf16(o0[4 * g + 2] * inv, o0[4 * g + 3] * inv);
        w1.x = cvt_pk_bf16(o1[4 * g] * inv, o1[4 * g + 1] * inv); w1.y = cvt_pk_bf16(o1[4 * g + 2] * inv, o1[4 * g + 3] * inv);
        stg_u2(orow + 8 * g + 4 * hi, w0); stg_u2(orow + 32 + 8 * g + 4 * hi, w1);
    }
    __syncthreads();
}

__device__ __forceinline__ float bf2f(unsigned short b) { return __uint_as_float((unsigned)b << 16); }
__device__ __forceinline__ void attn_conv_phase(Frame& F) {
    if (F.bid < 64 && F.G >= 128) {
        const int u = F.bid, b = u >> 5, h = (u >> 2) & 7, qb = u & 3, kvh = h >> 2;
        const size_t row0 = (size_t)MC + b * SEQ_L + qb * 256;
        attn_unit(F, F_QB + row0 * 512 + h * 64, F_KL + (size_t)b * KV_L * 128 + kvh * 64, F_VL + (size_t)b * KV_L * 128 + kvh * 64, KV_L / 64, F_HB + row0 * D + h * 64);
    } else {
        const int first = F.G >= 128 ? F.bid - 64 : F.bid, stride = F.G >= 128 ? F.G - 64 : F.G;
        if (F.G < 128) for (int u = F.bid; u < 64; u += F.G) { const int b = u >> 5, h = (u >> 2) & 7, qb = u & 3, kvh = h >> 2; const size_t row0 = (size_t)MC + b * SEQ_L + qb * 256;
            attn_unit(F, F_QB + row0 * 512 + h * 64, F_KL + (size_t)b * KV_L * 128 + kvh * 64, F_VL + (size_t)b * KV_L * 128 + kvh * 64, KV_L / 64, F_HB + row0 * D + h * 64); }
        for (int u = first; u < 256; u += stride) { const int b = u >> 3, h = u & 7, kvh = h >> 2; const size_t row0 = (size_t)b * SEQ_C;
            attn_unit(F, F_QB + row0 * 512 + h * 64, F_KC + row0 * 128 + kvh * 64, F_VC + row0 * 128 + kvh * 64, SEQ_C / 64, F_HB + row0 * D + h * 64); }
        const int gt = first * 512 + F.tid, NGT = stride * 512;
        for (int it = gt; it < M * 64; it += NGT) {
            const int row = it >> 6, ch = (it & 63) * 8;
            const int t = row < MC ? (row & (SEQ_C - 1)) : ((row - MC) & (SEQ_L - 1)), S = row < MC ? SEQ_C : SEQ_L;
            const u32x4 zero = {0u, 0u, 0u, 0u};
            const u32x4 uc = ldg_u4(F_UB + (size_t)row * 512 + ch);
            const u32x4 um = t > 0 ? ldg_u4(F_UB + (size_t)(row - 1) * 512 + ch) : zero;
            const u32x4 up = t < S - 1 ? ldg_u4(F_UB + (size_t)(row + 1) * 512 + ch) : zero;
            const u32x4 bg = ldg_u4(F_BGB + (size_t)row * 512 + ch);
            float r[8];
#pragma unroll
            for (int q = 0; q < 4; ++q) {
#pragma unroll
                for (int e = 0; e < 2; ++e) { const int cidx = ch + 2 * q + e; const int sh = e * 16;
                    const float a = bf2f((unsigned short)(um[q] >> sh)), b = bf2f((unsigned short)(uc[q] >> sh)), c = bf2f((unsigned short)(up[q] >> sh)), g = bf2f((unsigned short)(bg[q] >> sh));
                    r[2 * q + e] = g * (a * F_conv_w[cidx] + b * F_conv_w[512 + cidx] + c * F_conv_w[1024 + cidx]); }
            }
            u32x4 w; w.x = cvt_pk_bf16(r[0], r[1]); w.y = cvt_pk_bf16(r[2], r[3]); w.z = cvt_pk_bf16(r[4], r[5]); w.w = cvt_pk_bf16(r[6], r[7]);
            stg_u4(F_HB + (size_t)row * D + 512 + ch, w);
        }
    }
}

__global__ void __launch_bounds__(512, 2) fwd_megakernel(Args args) {
    extern __shared__ __attribute__((aligned(16))) unsigned char lds_raw[];
    Frame F;
    F.lds = (LAS unsigned char*)lds_raw;
    F.tid = threadIdx.x; F.lane = F.tid & 63; F.wave = __builtin_amdgcn_readfirstlane(F.tid >> 6); F.G = gridDim.x; F.bid = blockIdx.x;
    F.in = args.in; F.out = args.out; F.ws = args.ws;
    unsigned char* ws = args.ws;
    volatile LAS unsigned* MISC = (volatile LAS unsigned*)(F.lds + MISC_OFF);
    if (F.tid < 64) MISC[F.tid] = 0u;
    __syncthreads();
    XcdBarrier bar = xcd_barrier_post((unsigned*)(ws + WS_CTL) + 1024, MISC + 8);

    p0_prologue(F);
    xcd_barrier(bar);

    for (int step = 0; step < 20; ++step) {
        { int t_ = threadIdx.x; asm volatile("" : "+v"(t_)); F.tid = t_; F.lane = t_ & 63; F.wave = __builtin_amdgcn_readfirstlane(t_ >> 6);
          unsigned char* w_ = args.ws; asm volatile("" : "+s"(w_)); F.ws = w_; float* o_ = args.out; asm volatile("" : "+s"(o_)); F.out = o_;
          int b_ = blockIdx.x; asm volatile("" : "+s"(b_)); F.bid = b_; }
        float* const X = F.out;
        float* const outK = F.out + (size_t)M * D; float* const outV = outK + (size_t)MC * 128;
        int type = 0, f = 0, layer = 0, slot = 0;
        switch (step) {
            case 0: type = 0; layer = 0; slot = 0; break;   case 1: type = 1; f = 0; break;   case 2: type = 2; f = 0; break;
            case 3: type = 0; layer = 0; slot = 1; break;   case 4: type = 3; break;          case 5: type = 4; break;          case 6: type = 5; break;
            case 7: type = 0; layer = 0; slot = 2; break;   case 8: type = 1; f = 1; break;   case 9: type = 2; f = 1; break;
            case 10: type = 0; layer = 1; slot = 0; break;  case 11: type = 1; f = 2; break;  case 12: type = 2; f = 2; break;
            case 13: type = 6; layer = 1; slot = 1; break;  case 14: type = 7; break;         case 15: type = 8; break;
            case 16: type = 0; layer = 1; slot = 2; break;  case 17: type = 1; f = 3; break;  case 18: type = 2; f = 3; break;
            default: type = 9; break;
        }
        if (type == 0 || type == 6) {
            const float* modl = F_MOD + (size_t)layer * 3 * NMOD;
            const float* xc = step == 0 ? F_x_prompt : X; const float* xl = step == 0 ? F_x_sample : X + (size_t)MC * D;
            norm_pass(F, type == 6 ? 1 : 0, xc, xl, F_norm_g + (layer * 3 + slot) * D, modl + (3 * slot) * D, modl + (3 * slot + 1) * D);
        } else if (type == 1) {
            pg8::Gemm g{F_HB, F_W1T + (size_t)f * FF2 * D, D, D, D, 0}; pg8::StaticOrder S; S.init(M, FF2, F.G, F.bid);
            EpiSwiglu E{F_ACT};
            pg8::gemm_phase(F.lds, g, S, E, F.tid);
        } else if (type == 2 || type == 5 || type == 8) {
            const int l = f >> 1, which = f & 1;
            const bf16_t* A_ = type == 2 ? F_ACT : F_HB;
            const bf16_t* B_ = type == 2 ? F_W2T + (size_t)f * D * FF : (type == 5 ? F_WOUTT : F_WPOOLT);
            const int lda_ = type == 2 ? FF : D, ldb_ = type == 2 ? FF : (type == 5 ? D : 256), apn_ = type == 8 ? 256 : 0;
            const float* xc_ = step == 2 ? F_x_prompt : X; const float* xl_ = step == 2 ? F_x_sample : X + (size_t)MC * D;
            const float* gate_ = type == 2 ? F_MOD + (size_t)l * 3 * NMOD + (which ? 8 : 2) * D : (type == 5 ? F_MOD + 5 * D : F_MOD + (size_t)3 * NMOD + 5 * D);
            const float coef_ = type == 2 ? 0.5f : 1.0f; const float* cs_ = type == 8 ? F_pool_scale : nullptr;
            pg8::Gemm g{A_, B_, lda_, ldb_, ldb_, apn_}; EpiResid E{xc_, xl_, X, gate_, cs_, coef_, 0.f};
            pg8::StaticOrder S; S.init(M, D, F.G, F.bid);
            pg8::gemm_phase(F.lds, g, S, E, F.tid);
        } else if (type == 3) {
            pg8::Gemm g{F_HB, F_WINT, D, D, D, 0}; pg8::StaticOrder S; S.init(M, INW, F.G, F.bid);
            EpiInproj E{F_QB, F_KC, F_VC, F_KL, F_VL, F_UB, F_BGB, outK, outV, F_q_norm, F_k_norm, F_ROPE};
            pg8::gemm_phase(F.lds, g, S, E, F.tid);
        } else if (type == 4) {
            attn_conv_phase(F);
        } else if (type == 7) {
            pool_diff_pass(F, F_norm_g + (3 + 1) * D, F_MOD + (size_t)3 * NMOD + 4 * D);
        } else {
            norm_pass(F, 2, X, X + (size_t)MC * D, F_final_g, nullptr, nullptr);
        }
        if (step < 19) xcd_barrier(bar);
    }
}

extern "C" void kernel_launch(void* const* d_in, const int* in_sizes, int n_in, void* d_out, int out_size, void* d_ws, size_t ws_size, hipStream_t stream) {
    static int grid = 0;
    if (grid == 0) {
        if (n_in != 19 || ws_size < WS_END) { fprintf(stderr, "kernel_launch: unexpected n_in %d / ws %zu\n", n_in, ws_size); grid = -1; return; }
        int dev = 0, cus = 0, per_cu = 0;
        if (hipGetDevice(&dev) != hipSuccess || hipDeviceGetAttribute(&cus, hipDeviceAttributeMultiprocessorCount, dev) != hipSuccess) { grid = -1; return; }
        if (hipFuncSetAttribute((const void*)fwd_megakernel, hipFuncAttributeMaxDynamicSharedMemorySize, LDS_BYTES) != hipSuccess) { fprintf(stderr, "kernel_launch: hipFuncSetAttribute failed\n"); grid = -1; return; }
        if (hipOccupancyMaxActiveBlocksPerMultiprocessor(&per_cu, (const void*)fwd_megakernel, 512, LDS_BYTES) != hipSuccess || per_cu < 1) { fprintf(stderr, "kernel_launch: occupancy query says %d blocks/CU\n", per_cu); per_cu = 1; }
        (void)hipGetLastError();
        grid = cus;
        if (grid > 256) grid = 256;
    }
    if (grid < 0) return;
    (void)hipMemsetAsync((char*)d_ws + WS_CTL, 0, CTL_ZERO_BYTES, stream);
    Args a{};
    for (int i = 0; i < 19; ++i) a.in[i] = (const float*)d_in[i];
    a.out = (float*)d_out; a.ws = (unsigned char*)d_ws;
    void* params[] = {&a};
    hipError_t e = hipLaunchCooperativeKernel((const void*)fwd_megakernel, dim3(grid), dim3(512), params, LDS_BYTES, stream);
    if (e != hipSuccess) fprintf(stderr, "kernel_launch: cooperative launch failed: %s (grid %d)\n", hipGetErrorString(e), grid);
}
```
